# Optimizing an MI355X kernel written in HIP

```python
import jax, jax.numpy as jnp
from jax import lax
import numpy as np

D_MODEL = 1024
BATCH = 8
SEQ = 4096
DEPTH = 1

D_MIX = D_MODEL
D_CONV = D_MIX // 2
N_CONV_HEADS = 8
CONV_WIDTH = 31
D_POOL = D_MIX - D_CONV
POOL_WINDOWS = (2, 4, 8, 16)
N_POOL_GROUPS = len(POOL_WINDOWS)
POOL_GROUP_DIM = D_POOL // N_POOL_GROUPS
D_IN = 2 * D_CONV + D_POOL
D_FF = 2816
FFN_CONV_WIDTH = 3
EPS = 1e-6

kernel_name = "hybrid_conformer_pool_convffn_block"


def _rmsnorm(x, g):
    xf = x.astype(jnp.float32)
    y = xf * lax.rsqrt(jnp.mean(xf * xf, axis=-1, keepdims=True) + EPS)
    return (y * g.astype(jnp.float32)).astype(x.dtype)


def _layernorm(x, g, b):
    xf = x.astype(jnp.float32)
    mu = jnp.mean(xf, axis=-1, keepdims=True)
    xc = xf - mu
    var = jnp.mean(xc * xc, axis=-1, keepdims=True)
    y = xc * lax.rsqrt(var + EPS) * g.astype(jnp.float32) + b.astype(jnp.float32)
    return y.astype(x.dtype)


def _causal_dwconv(x, w, b):
    k, c = w.shape
    y = lax.conv_general_dilated(
        x, w[:, None, :].astype(x.dtype), window_strides=(1,),
        padding=((k - 1, 0),), dimension_numbers=("NWC", "WIO", "NWC"),
        feature_group_count=c)
    return y + b


def _conformer_conv_mixer(a_val, a_gate, conv_w, conv_b, ln_g, ln_b):
    h = a_val * jax.nn.sigmoid(a_gate)
    h = _causal_dwconv(h, conv_w, conv_b)
    h = _layernorm(h, ln_g, ln_b)
    return jax.nn.silu(h)


def _multiscale_pool_mixer(xb, pool_w, pool_scale):
    bsz, s, _ = xb.shape
    xg = xb.reshape(bsz, s, N_POOL_GROUPS, POOL_GROUP_DIM).astype(jnp.float32)
    cs = jnp.cumsum(xg, axis=1)
    pos = jnp.arange(1, s + 1, dtype=jnp.float32)
    outs = []
    for gi, w in enumerate(POOL_WINDOWS):
        c = cs[:, :, gi]
        lag = jnp.pad(c[:, : s - w], ((0, 0), (w, 0), (0, 0)))
        cnt = jnp.minimum(pos, float(w))[None, :, None]
        outs.append((c - lag) / cnt - xg[:, :, gi])
    d = jnp.stack(outs, axis=2).astype(xb.dtype)
    y = jnp.einsum("bsgc,gcd->bsgd", d, pool_w).reshape(bsz, s, D_POOL)
    return y * pool_scale


def setup_inputs(seed: int = 0) -> dict:
    key = jax.random.key(seed)
    ks = jax.random.split(key, 17)
    f32 = jnp.float32
    L = DEPTH

    def nrm(k, shape, scale):
        return jax.random.normal(k, shape, f32) * scale

    return {
        "x": jax.random.normal(ks[0], (BATCH, SEQ, D_MODEL), f32),
        "norm_mix_g": 1.0 + nrm(ks[1], (L, D_MODEL), 0.05),
        "w_in": nrm(ks[2], (L, D_MODEL, D_IN), D_MODEL ** -0.5),
        "conv_a_w": nrm(ks[3], (L, CONV_WIDTH, D_CONV), CONV_WIDTH ** -0.5),
        "conv_a_b": nrm(ks[4], (L, D_CONV), 0.02),
        "ln_a_g": 1.0 + nrm(ks[5], (L, D_CONV), 0.05),
        "ln_a_b": nrm(ks[6], (L, D_CONV), 0.02),
        "pool_w": nrm(ks[7], (L, N_POOL_GROUPS, POOL_GROUP_DIM, POOL_GROUP_DIM), POOL_GROUP_DIM ** -0.5),
        "pool_scale": 1.0 + nrm(ks[8], (L, D_POOL), 0.1),
        "w_out": nrm(ks[9], (L, D_MIX, D_MODEL), D_MIX ** -0.5),
        "norm_ffn_g": 1.0 + nrm(ks[10], (L, D_MODEL), 0.05),
        "w_up": nrm(ks[11], (L, D_MODEL, 2 * D_FF), D_MODEL ** -0.5),
        "conv_f_w": nrm(ks[12], (L, FFN_CONV_WIDTH, D_FF), FFN_CONV_WIDTH ** -0.5),
        "conv_f_b": nrm(ks[13], (L, D_FF), 0.02),
        "w_down": nrm(ks[14], (L, D_FF, D_MODEL), D_FF ** -0.5),
        "norm_final_g": 1.0 + nrm(ks[15], (D_MODEL,), 0.05),
    }


def reference(x, norm_mix_g, w_in, conv_a_w, conv_a_b, ln_a_g, ln_a_b, pool_w,
              pool_scale, w_out, norm_ffn_g, w_up, conv_f_w, conv_f_b, w_down,
              norm_final_g):
    for l in range(DEPTH):
        h = _rmsnorm(x, norm_mix_g[l])
        proj = h @ w_in[l]
        a_val, a_gate, b_in = jnp.split(proj, [D_CONV, 2 * D_CONV], axis=-1)
        ya = _conformer_conv_mixer(a_val, a_gate, conv_a_w[l], conv_a_b[l],
                                   ln_a_g[l], ln_a_b[l])
        yb = _multiscale_pool_mixer(b_in, pool_w[l], pool_scale[l])
        x = x + jnp.concatenate([ya, yb], axis=-1) @ w_out[l]
        h = _rmsnorm(x, norm_ffn_g[l])
        gate, val = jnp.split(h @ w_up[l], 2, axis=-1)
        gate = _causal_dwconv(gate, conv_f_w[l], conv_f_b[l])
        x = x + (jax.nn.silu(gate) * val) @ w_down[l]
    return _rmsnorm(x, norm_final_g)
```

```cpp
#include <hip/hip_runtime.h>
#include <cstdio>
#include <cstdint>
namespace pg8 {
#define PG8_LAS __attribute__((address_space(3)))
typedef unsigned short bf16_t;
typedef short bf16x8 __attribute__((ext_vector_type(8)));
typedef float f32x4 __attribute__((ext_vector_type(4)));
typedef unsigned u32x4 __attribute__((ext_vector_type(4)));
constexpr int BM = 256, BK = 64, HALF = 128, HTB = HALF * BK * 2  , STAGE_BYTES = 8 * HTB, NXCD = 8, WGM = 8;

__host__ __device__ __forceinline__ int lds_byte(int r, int c) { const int st = (r >> 4) * 2 + (c >> 5), rr = r & 15, cc = c & 31, ob = rr * 64 + cc * 2; return st * 1024 + (ob ^ (((ob >> 9) & 1) << 5)); }
__host__ __device__ __forceinline__ void stage_rc(int b, int& R, int& C) { const int st = b / 1024, sb = b % 1024, swz = sb ^ (((sb >> 9) & 1) << 5); R = (st >> 1) * 16 + swz / 64; C = (st & 1) * 32 + (swz % 64) / 2; }
__host__ __device__ __forceinline__ int perm32(int rho) { const int n = rho >> 4, i = rho & 15; return 8 * (i >> 2) + 4 * n + (i & 3); }

struct Unit { int pm, pn; };
struct Gemm { const bf16_t* A; const bf16_t* Bt; int M, N, K; };

struct StaticOrder {
    int nM, nN, nwg, G, c;
    __host__ __device__ void init(int M, int N, int G_, int c_) { nM = M / BM; nN = N / BM; nwg = nM * nN; G = G_; c = c_; }
    __host__ __device__ bool next(int i, Unit& u) const {
        const long L = (long)i * G + c; if (L >= nwg) return false;
        int wgid = (int)L; { const int q = nwg / NXCD, r = nwg % NXCD, xcd = wgid % NXCD, off = wgid / NXCD; wgid = (xcd < r ? xcd * (q + 1) : r * (q + 1) + (xcd - r) * q) + off; }
        const int nig = WGM * nN, gid = wgid / nig, fm = gid * WGM, gsz = (nM - fm) < WGM ? (nM - fm) : WGM;
        u.pm = fm + ((wgid % nig) % gsz); u.pn = (wgid % nig) / gsz; return true;
    }
    __device__ __forceinline__ void a_ready(const Unit&) const {}
    __device__ __forceinline__ void done(const Unit&) const {}
};

__device__ __forceinline__ unsigned cvt_pk_bf16(float lo, float hi) { unsigned r; asm volatile("v_cvt_pk_bf16_f32 %0, %1, %2" : "=v"(r) : "v"(lo), "v"(hi)); return r; }
typedef float f32x2 __attribute__((ext_vector_type(2)));
__device__ __forceinline__ float sigmoidf_fast(float v) { return __builtin_amdgcn_rcpf(1.0f + __builtin_amdgcn_exp2f(v * -1.4426950408889634f)); }

struct EpiIn {
    static constexpr bool PERM = true, AFTER_DRAIN = false;
    bf16_t* U;
    __device__ __forceinline__ void operator()(const f32x4 (&acc)[2][2][4][2], const Unit& u, int wr, int wc, int fr, int fq) const {
        const int row0 = u.pm * BM + wr * 64 + fr;
        if (u.pn < 4) {
            const int col0 = u.pn * 128 + wc * 32 + 8 * fq;
#pragma unroll
            for (int ai = 0; ai < 2; ++ai)
#pragma unroll
                for (int m = 0; m < 4; ++m) {
                    const f32x4 v0 = acc[ai][0][m][0], v1 = acc[ai][0][m][1], g0 = acc[ai][1][m][0], g1 = acc[ai][1][m][1];
                    u32x4 w;
                    w.x = cvt_pk_bf16(v0[0] * sigmoidf_fast(g0[0]), v0[1] * sigmoidf_fast(g0[1]));
                    w.y = cvt_pk_bf16(v0[2] * sigmoidf_fast(g0[2]), v0[3] * sigmoidf_fast(g0[3]));
                    w.z = cvt_pk_bf16(v1[0] * sigmoidf_fast(g1[0]), v1[1] * sigmoidf_fast(g1[1]));
                    w.w = cvt_pk_bf16(v1[2] * sigmoidf_fast(g1[2]), v1[3] * sigmoidf_fast(g1[3]));
                    *(u32x4*)(U + (size_t)(row0 + ai * HALF + m * 16) * 1024 + col0) = w;
                }
        } else {
            const int col0 = 512 + (u.pn - 4) * 256 + wc * 32 + 8 * fq;
#pragma unroll
            for (int ai = 0; ai < 2; ++ai)
#pragma unroll
                for (int m = 0; m < 4; ++m) {
                    bf16_t* rowp = U + (size_t)(row0 + ai * HALF + m * 16) * 1024 + col0;
#pragma unroll
                    for (int bj = 0; bj < 2; ++bj) {
                        const f32x4 v0 = acc[ai][bj][m][0], v1 = acc[ai][bj][m][1];
                        u32x4 w; w.x = cvt_pk_bf16(v0[0], v0[1]); w.y = cvt_pk_bf16(v0[2], v0[3]); w.z = cvt_pk_bf16(v1[0], v1[1]); w.w = cvt_pk_bf16(v1[2], v1[3]);
                        *(u32x4*)(rowp + bj * HALF) = w;
                    }
                }
        }
    }
};

struct EpiOut {
    static constexpr bool PERM = false, AFTER_DRAIN = false;
    const float* X; float* X1; bf16_t* X1B; float* SSQ;
    __device__ __forceinline__ void operator()(const f32x4 (&acc)[2][2][4][2], const Unit& u, int wr, int wc, int fr, int fq) const {
        typedef unsigned u32x2v __attribute__((ext_vector_type(2)));
        const int col0 = u.pn * BM + wc * 32 + 4 * fq;
#pragma unroll
        for (int ai = 0; ai < 2; ++ai)
#pragma unroll
            for (int m = 0; m < 4; ++m) {
                const int row = u.pm * BM + ai * HALF + wr * 64 + m * 16 + fr; const size_t off = (size_t)row * 1024 + col0; float s = 0.f;
#pragma unroll
                for (int bj = 0; bj < 2; ++bj)
#pragma unroll
                    for (int n = 0; n < 2; ++n) {
                        const f32x4 xin = *(const f32x4*)(X + off + bj * HALF + n * 16); const f32x4 v = xin + acc[ai][bj][m][n];
                        *(f32x4*)(X1 + off + bj * HALF + n * 16) = v; s += (v[0] * v[0] + v[1] * v[1]) + (v[2] * v[2] + v[3] * v[3]);
                        u32x2v w; w.x = cvt_pk_bf16(v[0], v[1]); w.y = cvt_pk_bf16(v[2], v[3]); *(u32x2v*)(X1B + off + bj * HALF + n * 16) = w;
                    }
                s += __shfl_xor(s, 16); s += __shfl_xor(s, 32);
                if (fq == 0) SSQ[(size_t)row * 16 + u.pn * 4 + wc] = s;
                if (m & 1) asm volatile("" ::: "memory");
            }
    }
};

__device__ __forceinline__ float row_rstd16(const float* SSQ, int row) {
    const f32x4* p = (const f32x4*)(SSQ + (size_t)row * 16); const f32x4 a = p[0], b = p[1], c = p[2], d = p[3];
    const float s = ((a[0] + a[1]) + (a[2] + a[3])) + ((b[0] + b[1]) + (b[2] + b[3])) + ((c[0] + c[1]) + (c[2] + c[3])) + ((d[0] + d[1]) + (d[2] + d[3]));
    return 1.0f / sqrtf(s * (1.0f / 1024.0f) + 1e-6f);
}

struct EpiUpRaw {
    static constexpr bool PERM = true, AFTER_DRAIN = false;
    bf16_t* G; bf16_t* V; const float* SSQ;
    __device__ __forceinline__ void operator()(const f32x4 (&acc)[2][2][4][2], const Unit& u, int wr, int wc, int fr, int fq) const {
        const int col0 = u.pn * 128 + wc * 32 + 8 * fq;
#pragma unroll
        for (int ai = 0; ai < 2; ++ai)
#pragma unroll
            for (int m = 0; m < 4; ++m) {
                const int row = u.pm * BM + ai * HALF + wr * 64 + m * 16 + fr; const float r = row_rstd16(SSQ, row);
#pragma unroll
                for (int bj = 0; bj < 2; ++bj) {
                    const f32x4 v0 = acc[ai][bj][m][0] * r, v1 = acc[ai][bj][m][1] * r;
                    u32x4 w; w.x = cvt_pk_bf16(v0[0], v0[1]); w.y = cvt_pk_bf16(v0[2], v0[3]); w.z = cvt_pk_bf16(v1[0], v1[1]); w.w = cvt_pk_bf16(v1[2], v1[3]);
                    *(u32x4*)((bj == 0 ? G : V) + (size_t)row * 2816 + col0) = w;
                }
            }
    }
};

struct EpiDown {
    static constexpr bool PERM = false, AFTER_DRAIN = false;
    float* OUT;
    __device__ __forceinline__ void operator()(const f32x4 (&acc)[2][2][4][2], const Unit& u, int wr, int wc, int fr, int fq) const {
        const int col0 = u.pn * BM + wc * 32 + 4 * fq;
#pragma unroll
        for (int ai = 0; ai < 2; ++ai)
#pragma unroll
            for (int m = 0; m < 4; ++m) {
                const size_t off = (size_t)(u.pm * BM + ai * HALF + wr * 64 + m * 16 + fr) * 1024 + col0;
#pragma unroll
                for (int bj = 0; bj < 2; ++bj)
#pragma unroll
                    for (int n = 0; n < 2; ++n) { const f32x4 xin = *(const f32x4*)(OUT + off + bj * HALF + n * 16); *(f32x4*)(OUT + off + bj * HALF + n * 16) = xin + acc[ai][bj][m][n]; }
                if (m & 1) asm volatile("" ::: "memory");
            }
    }
};

template <class Epi, class Sched, bool ALIGN_EPI = false, bool SP2 = false>
__device__ __forceinline__ void gemm_phase(PG8_LAS unsigned char* lds, const Gemm g, const Sched& S, const Epi& E) {
    const int tid = threadIdx.x, wid = __builtin_amdgcn_readfirstlane(tid >> 6), lane = tid & 63, wr = wid >> 2, wc = wid & 3, fr = lane & 15, fq = lane >> 4;
    const int K = g.K, nt = K / BK;
    unsigned voffA[2], voffB[2];
#pragma unroll
    for (int i = 0; i < 2; ++i) { int R, C; stage_rc(tid * 16 + i * 8192, R, C); const int Rb = Epi::PERM ? ((R & ~31) + perm32(R & 31)) : R;
        voffA[i] = (unsigned)(R * K + C) * 2u; voffB[i] = (unsigned)(Rb * K + C) * 2u; }
    const size_t kstep = (size_t)(BK * 2);
    const size_t hstep = (size_t)HALF * K * 2;
    const size_t tstep = 2 * hstep;
    const unsigned ldsw = (unsigned)wid * 1024u;
    const int aoff = lds_byte(wr * 64 + fr, fq * 8), boff = lds_byte(wc * 32 + fr, fq * 8);
#define PG8_SA(b, h) (((b) * 2 + (h)) * HTB)
#define PG8_SB(b, h) ((4 + (b) * 2 + (h)) * HTB)
#define PG8_STAGE(bufoff, gbase, voff) do { _Pragma("unroll") for (int _i = 0; _i < 2; ++_i) \
        __builtin_amdgcn_global_load_lds((const unsigned*)((const char*)(gbase) + (voff)[_i]), (PG8_LAS unsigned*)(lds + (bufoff) + ldsw + _i * 8192), 16, 0, 0); } while (0)
#define PG8_LDA(dst, b, h) do { _Pragma("unroll") for (int m = 0; m < 4; ++m) _Pragma("unroll") for (int k = 0; k < 2; ++k) dst[m][k] = *(const PG8_LAS bf16x8*)(lds + PG8_SA(b, h) + aoff + m * 2048 + k * 1024); } while (0)
#define PG8_LDB(dst, b, h) do { _Pragma("unroll") for (int n = 0; n < 2; ++n) _Pragma("unroll") for (int k = 0; k < 2; ++k) dst[n][k] = *(const PG8_LAS bf16x8*)(lds + PG8_SB(b, h) + boff + n * 2048 + k * 1024); } while (0)
#define PG8_MMA(ai, bj, At, Bt) do { __builtin_amdgcn_s_setprio(1); _Pragma("unroll") for (int m = 0; m < 4; ++m) _Pragma("unroll") for (int n = 0; n < 2; ++n) _Pragma("unroll") for (int k = 0; k < 2; ++k) \
        acc[ai][bj][m][n] = __builtin_amdgcn_mfma_f32_16x16x32_bf16(Bt[n][k], At[m][k], acc[ai][bj][m][n], 0, 0, 0); __builtin_amdgcn_s_setprio(0); } while (0)
#define PG8_WAIT_V(n) asm volatile("s_waitcnt vmcnt(" #n ")" ::: "memory")
#define PG8_WAIT_L(n) asm volatile("s_waitcnt lgkmcnt(" #n ")" ::: "memory")
#define PG8_BAR __builtin_amdgcn_s_barrier()
#define PG8_SCHED __builtin_amdgcn_sched_barrier(0)
    Unit cur, nxt; int ui = 0;
    if (!S.next(0, cur)) return;
    f32x4 acc[2][2][4][2];
#pragma unroll
    for (int a = 0; a < 2; ++a)
#pragma unroll
        for (int b = 0; b < 2; ++b)
#pragma unroll
            for (int m = 0; m < 4; ++m)
#pragma unroll
                for (int n = 0; n < 2; ++n) acc[a][b][m][n] = (f32x4){0.f, 0.f, 0.f, 0.f};
    bf16x8 At[4][2], B0[2][2], B1[2][2];
    const char* cA = (const char*)g.A + (size_t)cur.pm * tstep; const char* cB = (const char*)g.Bt + (size_t)cur.pn * tstep;
    S.a_ready(cur);
    if constexpr (SP2) {
        PG8_STAGE(PG8_SB(0, 0), cB, voffB); PG8_STAGE(PG8_SB(0, 1), cB + hstep, voffB); PG8_STAGE(PG8_SA(0, 0), cA, voffA); PG8_STAGE(PG8_SA(0, 1), cA + hstep, voffA);
        if (wr == 1) PG8_BAR;
        PG8_WAIT_V(2); PG8_BAR;
        PG8_STAGE(PG8_SB(1, 0), cB + kstep, voffB); PG8_STAGE(PG8_SA(1, 0), cA + kstep, voffA); PG8_STAGE(PG8_SB(1, 1), cB + hstep + kstep, voffB);
        PG8_WAIT_V(6); PG8_BAR;
    } else {
        PG8_STAGE(PG8_SB(0, 0), cB, voffB); PG8_STAGE(PG8_SA(0, 0), cA, voffA); PG8_STAGE(PG8_SB(0, 1), cB + hstep, voffB); PG8_STAGE(PG8_SA(0, 1), cA + hstep, voffA);
        if (wr == 1) PG8_BAR;
        PG8_WAIT_V(4); PG8_BAR;
        PG8_STAGE(PG8_SB(1, 0), cB + kstep, voffB); PG8_STAGE(PG8_SA(1, 0), cA + kstep, voffA); PG8_STAGE(PG8_SB(1, 1), cB + hstep + kstep, voffB);
        PG8_WAIT_V(6); PG8_BAR;
    }
    for (;;) {
        const bool has_next = S.next(ui + 1, nxt);
        const char* nA = has_next ? (const char*)g.A + (size_t)nxt.pm * tstep : cA; const char* nB = has_next ? (const char*)g.Bt + (size_t)nxt.pn * tstep : cB;
        for (int t = 0; t < nt; t += 2) {
            const bool last = (t == nt - 2);
            const char* a1 = cA + (size_t)(t + 1) * kstep;
            const char* a2 = last ? nA : cA + (size_t)(t + 2) * kstep; const char* b2 = last ? nB : cB + (size_t)(t + 2) * kstep;
            const char* a3 = a2 + kstep; const char* b3 = b2 + kstep;
            if (last && has_next) S.a_ready(nxt);
            if constexpr (SP2) {
            PG8_LDB(B0, 0, 0); PG8_LDB(B1, 0, 1); PG8_SCHED; PG8_LDA(At, 0, 0); PG8_STAGE(PG8_SA(1, 1), a1 + hstep, voffA);
            PG8_WAIT_V(8); PG8_WAIT_L(0); PG8_BAR; PG8_MMA(0, 0, At, B0); PG8_MMA(0, 1, At, B1); PG8_BAR; PG8_SCHED;
            PG8_LDA(At, 0, 1); PG8_STAGE(PG8_SB(0, 0), b2, voffB); PG8_STAGE(PG8_SB(0, 1), b2 + hstep, voffB); PG8_STAGE(PG8_SA(0, 0), a2, voffA);
            PG8_WAIT_V(8); PG8_WAIT_L(0); PG8_BAR; PG8_MMA(1, 0, At, B0); PG8_MMA(1, 1, At, B1); PG8_BAR; PG8_SCHED;
            PG8_LDB(B0, 1, 0); PG8_LDB(B1, 1, 1); PG8_SCHED; PG8_LDA(At, 1, 0); PG8_STAGE(PG8_SA(0, 1), a2 + hstep, voffA);
            PG8_WAIT_V(8); PG8_WAIT_L(0); PG8_BAR; PG8_MMA(0, 0, At, B0); PG8_MMA(0, 1, At, B1); PG8_BAR; PG8_SCHED;
            PG8_LDA(At, 1, 1); PG8_STAGE(PG8_SB(1, 0), b3, voffB); PG8_STAGE(PG8_SB(1, 1), b3 + hstep, voffB); PG8_STAGE(PG8_SA(1, 0), a3, voffA);
            PG8_WAIT_V(8); PG8_WAIT_L(0); PG8_BAR; PG8_MMA(1, 0, At, B0); PG8_MMA(1, 1, At, B1); PG8_BAR; PG8_SCHED;
            } else {
            PG8_LDB(B0, 0, 0); PG8_SCHED; PG8_LDA(At, 0, 0); PG8_STAGE(PG8_SA(1, 1), a1 + hstep, voffA);
            PG8_WAIT_L(8); PG8_BAR; PG8_WAIT_L(0); PG8_MMA(0, 0, At, B0); PG8_BAR; PG8_SCHED;
            PG8_LDB(B1, 0, 1); PG8_STAGE(PG8_SB(0, 0), b2, voffB);
            PG8_BAR; PG8_WAIT_L(0); PG8_MMA(0, 1, At, B1); PG8_BAR;
            PG8_LDA(At, 0, 1); PG8_STAGE(PG8_SA(0, 0), a2, voffA);
            PG8_BAR; PG8_WAIT_L(0); PG8_MMA(1, 0, At, B0); PG8_BAR; PG8_SCHED;
            PG8_STAGE(PG8_SB(0, 1), b2 + hstep, voffB);
            PG8_WAIT_V(6); PG8_BAR; PG8_MMA(1, 1, At, B1); PG8_BAR;
            PG8_LDB(B0, 1, 0); PG8_SCHED; PG8_LDA(At, 1, 0); PG8_STAGE(PG8_SA(0, 1), a2 + hstep, voffA);
            PG8_WAIT_L(8); PG8_BAR; PG8_WAIT_L(0); PG8_MMA(0, 0, At, B0); PG8_BAR; PG8_SCHED;
            PG8_LDB(B1, 1, 1); PG8_STAGE(PG8_SB(1, 0), b3, voffB);
            PG8_BAR; PG8_WAIT_L(0); PG8_MMA(0, 1, At, B1); PG8_BAR;
            PG8_LDA(At, 1, 1); PG8_STAGE(PG8_SA(1, 0), a3, voffA);
            PG8_BAR; PG8_WAIT_L(0); PG8_MMA(1, 0, At, B0); PG8_BAR; PG8_SCHED;
            PG8_STAGE(PG8_SB(1, 1), b3 + hstep, voffB);
            PG8_WAIT_V(6); PG8_BAR; PG8_MMA(1, 1, At, B1); PG8_BAR;
            }
        }
        if constexpr (ALIGN_EPI) { if (wr == 0) PG8_BAR; }
        if constexpr (!Epi::AFTER_DRAIN) { E(acc, cur, wr, wc, fr, fq); S.done(cur); }
        if (!has_next) break;
#pragma unroll
        for (int a = 0; a < 2; ++a)
#pragma unroll
            for (int b = 0; b < 2; ++b)
#pragma unroll
                for (int m = 0; m < 4; ++m)
#pragma unroll
                    for (int n = 0; n < 2; ++n) acc[a][b][m][n] = (f32x4){0.f, 0.f, 0.f, 0.f};
        cur = nxt; cA = nA; cB = nB; ++ui;
        if constexpr (ALIGN_EPI) { if (wr == 1) PG8_BAR; }
    }
    PG8_WAIT_V(0);
    if constexpr (!ALIGN_EPI) { if (wr == 0) PG8_BAR; }
    PG8_BAR;
    if constexpr (Epi::AFTER_DRAIN) { E.fused(acc, cur, wr, wc, fr, fq, lds, wid, lane); S.done(cur); }
#undef PG8_SA
#undef PG8_SB
#undef PG8_STAGE
#undef PG8_LDA
#undef PG8_LDB
#undef PG8_MMA
#undef PG8_WAIT_V
#undef PG8_WAIT_L
#undef PG8_BAR
#undef PG8_SCHED
}
}
constexpr int NWAVES = 8;
#ifndef MK_N_LAUNCHES
#define MK_N_LAUNCHES 8
#endif
constexpr int N_LAUNCHES = MK_N_LAUNCHES;
constexpr int PER_PHASE = 8;
constexpr int M = 32768, SEQ = 4096, D = 1024, DCONV = 512, DPOOL = 512, DIN = 1536, DFF = 2816, NUP = 5632, CW = 31;
constexpr float EPS = 1e-6f;
constexpr size_t MiB = 1u << 20;
constexpr size_t WS_CTL = 0, CTL_ZERO_BYTES = 64 * 1024;
constexpr size_t WS_WIN = 1 * MiB, WS_WOUT = 4 * MiB, WS_WUP = 6 * MiB, WS_WDOWN = 17 * MiB, WS_POOLW = 23 * MiB, WS_SSQ = 24 * MiB;
constexpr size_t WS_XN = 32 * MiB;
constexpr size_t WS_U = 96 * MiB;
constexpr size_t WS_MIX = 160 * MiB;
constexpr size_t WS_G = 96 * MiB;
constexpr size_t WS_ACT = 272 * MiB;
constexpr size_t WS_END = 448 * MiB;
constexpr int CW_BAR = 1024;

constexpr int RING_OFF = 0, RING_BYTES = 131072;
constexpr int LDSCTL_OFF = RING_BYTES, MISC_OFF = LDSCTL_OFF + 320;
constexpr int LDS_BYTES = 147456;

#define GAS __attribute__((address_space(1)))
#define LAS __attribute__((address_space(3)))
typedef unsigned short bf16;
typedef unsigned v4u __attribute__((ext_vector_type(4)));
typedef unsigned v2u __attribute__((ext_vector_type(2)));
typedef float f32x4 __attribute__((ext_vector_type(4)));
typedef float f32x2 __attribute__((ext_vector_type(2)));
typedef short bf16x8 __attribute__((ext_vector_type(8)));
typedef GAS unsigned gu32;
#define RLX_AGENT __ATOMIC_RELAXED, __HIP_MEMORY_SCOPE_AGENT
#define LDS_WAIT() asm volatile("s_waitcnt lgkmcnt(0)" ::: "memory")
#define VM_WAIT() asm volatile("s_waitcnt vmcnt(0)" ::: "memory")
__device__ __forceinline__ unsigned pk2(float lo, float hi) { return pg8::cvt_pk_bf16(lo, hi); }
__device__ __forceinline__ float bflo(unsigned u) { return __builtin_bit_cast(float, u << 16); }
__device__ __forceinline__ float bfhi(unsigned u) { return __builtin_bit_cast(float, u & 0xffff0000u); }
__device__ __forceinline__ float silu_fast(float v) { return v * __builtin_amdgcn_rcpf(1.0f + __builtin_amdgcn_exp2f(v * -1.4426950408889634f)); }

#define XB_TMO      128
#define XB_XCNT(j)  (256  + 64 * (j))
#define XB_XSUB(j)  (1280 + 64 * (j))
#define XB_XGEN(j)  (2304 + 64 * (j))
#define XB_TOP      3328
#define XB_TOPGEN   3392
#define XCD_BAR_WORDS 3456
#define XB_SPIN_CAP (1u << 18)

__device__ __forceinline__ unsigned xb_ld(unsigned* p)              { return __hip_atomic_load(p, __ATOMIC_RELAXED, __HIP_MEMORY_SCOPE_AGENT); }
__device__ __forceinline__ unsigned xb_add(unsigned* p, unsigned v) { return __hip_atomic_fetch_add(p, v, __ATOMIC_RELAXED, __HIP_MEMORY_SCOPE_AGENT); }
__device__ __forceinline__ unsigned xb_xcc_id() { return (unsigned)__builtin_amdgcn_s_getreg((3 << 11) | 20) & 0xFu; }
#define XB_SPIN(cond, bar) do { unsigned _sp = 0; while (cond) { __builtin_amdgcn_s_sleep(1); \
    if ((++_sp & 255u) == 0u) { if (xb_ld(&(bar)[XB_TMO])) break; if (_sp > XB_SPIN_CAP) { atomicAdd(&(bar)[XB_TMO], 1u); break; } } } } while (0)

struct XcdBarrier {
    unsigned* bar; unsigned x;
    volatile LAS unsigned* st;
};

__device__ __forceinline__ XcdBarrier xcd_barrier_post(unsigned* bar, volatile LAS unsigned* st) {
    XcdBarrier b; b.bar = bar; b.x = xb_xcc_id(); b.st = st;
    if (threadIdx.x == 0) (void)xb_add(&bar[XB_XCNT(b.x)], 1u);
    return b;
}
__device__ __forceinline__ void xcd_barrier_complete(unsigned* bar, unsigned x, unsigned& nloc, unsigned& nx) {
    const unsigned G = gridDim.x * gridDim.y * gridDim.z;
    unsigned sum, cnt, mine, sp = 0u;
    for (;;) {
        sum = 0u; cnt = 0u; mine = 0u;
#pragma unroll
        for (unsigned j = 0; j < 16; ++j) { const unsigned c = xb_ld(&bar[XB_XCNT(j)]); sum += c; cnt += (c > 0u) ? 1u : 0u; mine = (j == x) ? c : mine; }
        if (sum == G) break;
        __builtin_amdgcn_s_sleep(1);
        if ((++sp & 255u) == 0u) { if (xb_ld(&bar[XB_TMO])) break; if (sp > XB_SPIN_CAP) { atomicAdd(&bar[XB_TMO], 1u); break; } }
    }
    nloc = mine > 0u ? mine : 1u; nx = cnt > 0u ? cnt : 1u;
}

__device__ __forceinline__ void xcd_barrier(const XcdBarrier& b) {
    asm volatile("s_waitcnt vmcnt(0)" ::: "memory");
    __syncthreads();
    if (threadIdx.x == 0) {
        unsigned* bar = b.bar;
        __builtin_amdgcn_s_waitcnt(0);
        unsigned nloc = b.st[0], nx = b.st[1];
        if (nloc == 0u) { xcd_barrier_complete(bar, b.x, nloc, nx); b.st[0] = nloc; b.st[1] = nx; }
        const unsigned old = xb_add(&bar[XB_XSUB(b.x)], 1u);
        const unsigned gen = old / nloc;
        if (old + 1u == (gen + 1u) * nloc) {
            __builtin_amdgcn_fence(__ATOMIC_RELEASE, "agent");
            asm volatile("s_waitcnt vmcnt(0)" ::: "memory");
            const unsigned og = xb_add(&bar[XB_TOP], 1u);
            const unsigned tg = og / nx;
            if (og + 1u == (tg + 1u) * nx) xb_add(&bar[XB_TOPGEN], 1u);
            else XB_SPIN(xb_ld(&bar[XB_TOPGEN]) == tg, bar);
            __builtin_amdgcn_fence(__ATOMIC_ACQUIRE, "agent");
            xb_add(&bar[XB_XGEN(b.x)], 1u);
            asm volatile("s_waitcnt vmcnt(0)" ::: "memory");
        } else {
            XB_SPIN(xb_ld(&bar[XB_XGEN(b.x)]) == gen, bar);
            __builtin_amdgcn_fence(__ATOMIC_ACQUIRE, "agent");
            asm volatile("s_waitcnt vmcnt(0)" ::: "memory");
        }
    }
    __syncthreads();
}

struct Frame {
    LAS unsigned char* lds;
    volatile LAS unsigned* MISC;
    gu32* ctl;
    int tid, lane, wave, vcu, G;
    const float *x, *norm_mix_g, *w_in, *conv_a_w, *conv_a_b, *ln_a_g, *ln_a_b, *pool_w, *pool_scale, *w_out, *norm_ffn_g, *w_up, *conv_f_w, *conv_f_b, *w_down, *norm_final_g;
    float* out;
    bf16 *Win_t, *Wout_t, *Wup_t, *Wdown_t, *PoolW_t, *XN, *U, *MIX, *Gb, *ACT;
    float* SSQ;
};

__device__ __forceinline__ float wave_sum(float v) {
#pragma unroll
    for (int o = 1; o < 64; o <<= 1) v += __shfl_xor(v, o);
    return v;
}
__device__ __forceinline__ void p0_transpose_item(const float* W, int K, int N, bf16* WT, int k0, int n0, int drow0, const float* gk, LAS float* scr, int lane) {
#pragma unroll 8
    for (int i = 0; i < 32; ++i) { const int kk = 2 * i + (lane >> 5); float v = W[(size_t)(k0 + kk) * N + n0 + (lane & 31)]; if (gk) v *= gk[k0 + kk]; scr[kk * 33 + (lane & 31)] = v; }
    LDS_WAIT(); asm volatile("" ::: "memory");
    const int c = lane & 7;
#pragma unroll
    for (int j = 0; j < 4; ++j) { const int n = (lane >> 3) + 8 * j; const LAS float* s = scr + (8 * c) * 33 + n;
        v4u o; o.x = pk2(s[0 * 33], s[1 * 33]); o.y = pk2(s[2 * 33], s[3 * 33]); o.z = pk2(s[4 * 33], s[5 * 33]); o.w = pk2(s[6 * 33], s[7 * 33]);
        *(GAS v4u*)(WT + (size_t)(drow0 + n) * K + k0 + 8 * c) = o; }
    LDS_WAIT(); asm volatile("" ::: "memory");
}
__device__ __forceinline__ int pair_row(int n0, int half) { const int h = n0 >= half ? 1 : 0, ch = n0 - h * half; return (ch >> 7) * 256 + h * 128 + (ch & 127); }

__device__ __forceinline__ void p0_prologue(Frame& F) {
    LAS float* scr = (LAS float*)(F.lds + RING_OFF + F.wave * 16384);
    const int gw = F.vcu * NWAVES + F.wave, NGW = F.G * NWAVES;
    constexpr int I_IN = (D / 64) * (DIN / 32), I_OUT = (D / 64) * (D / 32), I_UP = (D / 64) * (NUP / 32), I_DN = (DFF / 64) * (D / 32), I_PW = 4 * (128 / 64) * (128 / 32);
    constexpr int NITEMS = I_IN + I_OUT + I_UP + I_DN + I_PW;
    for (int it = gw; it < NITEMS; it += NGW) {
        int r = it;
        if (r < I_IN) { const int nb = DIN / 32, k0 = 64 * (r / nb), n0 = 32 * (r % nb); const int dr = n0 < 1024 ? pair_row(n0, 512) : n0;
            p0_transpose_item(F.w_in, D, DIN, F.Win_t, k0, n0, dr, nullptr, scr, F.lane); continue; } r -= I_IN;
        if (r < I_OUT) { const int nb = D / 32, k0 = 64 * (r / nb), n0 = 32 * (r % nb); p0_transpose_item(F.w_out, D, D, F.Wout_t, k0, n0, n0, nullptr, scr, F.lane); continue; } r -= I_OUT;
        if (r < I_UP) { const int nb = NUP / 32, k0 = 64 * (r / nb), n0 = 32 * (r % nb); p0_transpose_item(F.w_up, D, NUP, F.Wup_t, k0, n0, pair_row(n0, DFF), F.norm_ffn_g, scr, F.lane); continue; } r -= I_UP;
        if (r < I_DN) { const int nb = D / 32, k0 = 64 * (r / nb), n0 = 32 * (r % nb); p0_transpose_item(F.w_down, DFF, D, F.Wdown_t, k0, n0, n0, nullptr, scr, F.lane); continue; } r -= I_DN;
        { const int g = r / 8, q = r % 8, k0 = 64 * (q / 4), n0 = 32 * (q % 4); p0_transpose_item(F.pool_w + g * 16384, 128, 128, F.PoolW_t + g * 16384, k0, n0, n0, nullptr, scr, F.lane); }
    }
    f32x4 gv[4];
#pragma unroll
    for (int j = 0; j < 4; ++j) gv[j] = ((const f32x4*)F.norm_mix_g)[F.lane + 64 * j];
    for (int m = gw; m < M; m += NGW) {
        const GAS f32x4* xr = (const GAS f32x4*)(F.x + (size_t)m * D) + F.lane;
        f32x4 v[4]; float s = 0.f;
#pragma unroll
        for (int j = 0; j < 4; ++j) { v[j] = xr[64 * j]; s += (v[j].x * v[j].x + v[j].y * v[j].y) + (v[j].z * v[j].z + v[j].w * v[j].w); }
        const float rstd = 1.f / sqrtf(wave_sum(s) * (1.f / D) + EPS);
        GAS v2u* o8 = (GAS v2u*)(F.XN + (size_t)m * D) + F.lane;
#pragma unroll
        for (int j = 0; j < 4; ++j) { v2u w; w.x = pk2(v[j].x * rstd * gv[j].x, v[j].y * rstd * gv[j].y); w.y = pk2(v[j].z * rstd * gv[j].z, v[j].w * rstd * gv[j].w); o8[64 * j] = w; }
    }
}

constexpr int P2_TOK = 32, P2_CONV_OFF = 0, P2_DA_OFF = 65536, P2_DA_PITCH = 1040;
template <int W> __device__ __forceinline__ void pool_d_tile(const unsigned* Uu, int t0, int s0, int tb, int c2, LAS unsigned char* lds) {
    unsigned in[31];
#pragma unroll
    for (int j = 0; j < 31; ++j) { if (j >= 15 - (W - 1)) { const int sp = s0 + tb - 15 + j; in[j] = sp >= 0 ? Uu[(size_t)(t0 + tb - 15 + j) * 512 + 256 + c2] : 0u; } else in[j] = 0u; }
#pragma unroll
    for (int i = 0; i < 16; ++i) {
        float a0 = 0.f, a1 = 0.f;
#pragma unroll
        for (int jj = 0; jj < W; ++jj) { a0 += bflo(in[15 + i - jj]); a1 += bfhi(in[15 + i - jj]); }
        const int pos = s0 + tb + i; const float cnt = (float)(pos + 1 < W ? pos + 1 : W); const float inv = 1.0f / cnt;
        const float d0 = a0 * inv - bflo(in[15 + i]), d1 = a1 * inv - bfhi(in[15 + i]);
        *(LAS unsigned*)(lds + P2_DA_OFF + (tb + i) * P2_DA_PITCH + c2 * 4) = pk2(d0, d1);
    }
}
__device__ __forceinline__ void p2_mixers(Frame& F) {
    const int tid = F.tid, lane = F.lane, wave = F.wave, c2 = tid & 255, half = tid >> 8, fr = lane & 15, fq = lane >> 4;
    const unsigned* Uu = (const unsigned*)F.U;
    float cw[CW][2];
#pragma unroll
    for (int k = 0; k < CW; ++k) { const f32x2 w = *(const f32x2*)(F.conv_a_w + k * DCONV + 2 * c2); cw[k][0] = w.x; cw[k][1] = w.y; }
    const f32x2 cb = *(const f32x2*)(F.conv_a_b + 2 * c2);
    const f32x4 lg0 = *(const f32x4*)(F.ln_a_g + 4 * lane), lg1 = *(const f32x4*)(F.ln_a_g + 256 + 4 * lane), lb0 = *(const f32x4*)(F.ln_a_b + 4 * lane), lb1 = *(const f32x4*)(F.ln_a_b + 256 + 4 * lane);
    const int pg = wave >> 1, nh = wave & 1;
    LAS float* convout = (LAS float*)(F.lds + P2_CONV_OFF);
    for (int tile = F.vcu; tile < M / P2_TOK; tile += F.G) {
        const int t0 = tile * P2_TOK, s0 = t0 & (SEQ - 1);
#pragma unroll 1
        for (int blk = 0; blk < 2; ++blk) {
            const int tb = half * 16 + blk * 8;
            unsigned in[38];
#pragma unroll
            for (int j = 0; j < 38; ++j) { const int sp = s0 + tb - 30 + j; in[j] = sp >= 0 ? Uu[(size_t)(t0 + tb - 30 + j) * 512 + c2] : 0u; }
            float a[8][2];
#pragma unroll
            for (int t = 0; t < 8; ++t) { a[t][0] = cb.x; a[t][1] = cb.y; }
#pragma unroll
            for (int j = 0; j < 38; ++j) { const float lo = bflo(in[j]), hi = bfhi(in[j]);
#pragma unroll
                for (int t = 0; t < 8; ++t) { const int k = j - t; if (k >= 0 && k < CW) { a[t][0] += cw[k][0] * lo; a[t][1] += cw[k][1] * hi; } } }
#pragma unroll
            for (int t = 0; t < 8; ++t) *(LAS f32x2*)(convout + (tb + t) * 512 + 2 * c2) = (f32x2){a[t][0], a[t][1]};
        }
        { const int grp = c2 >> 6, tb = half * 16;
          if (grp == 0) pool_d_tile<2>(Uu, t0, s0, tb, c2, F.lds); else if (grp == 1) pool_d_tile<4>(Uu, t0, s0, tb, c2, F.lds);
          else if (grp == 2) pool_d_tile<8>(Uu, t0, s0, tb, c2, F.lds); else pool_d_tile<16>(Uu, t0, s0, tb, c2, F.lds); }
        __syncthreads();
#pragma unroll
        for (int q = 0; q < 4; ++q) {
            const int tok = 4 * wave + q;
            const f32x4 v0 = *(const LAS f32x4*)(convout + tok * 512 + 4 * lane), v1 = *(const LAS f32x4*)(convout + tok * 512 + 256 + 4 * lane);
            const float mean = wave_sum(((v0.x + v0.y) + (v0.z + v0.w)) + ((v1.x + v1.y) + (v1.z + v1.w))) * (1.0f / DCONV);
            const f32x4 e0 = v0 - mean, e1 = v1 - mean;
            const float var = wave_sum(((e0.x * e0.x + e0.y * e0.y) + (e0.z * e0.z + e0.w * e0.w)) + ((e1.x * e1.x + e1.y * e1.y) + (e1.z * e1.z + e1.w * e1.w))) * (1.0f / DCONV);
            const float rstd = 1.0f / sqrtf(var + EPS);
            const f32x4 y0 = e0 * rstd * lg0 + lb0, y1 = e1 * rstd * lg1 + lb1;
            v2u w0, w1; w0.x = pk2(silu_fast(y0.x), silu_fast(y0.y)); w0.y = pk2(silu_fast(y0.z), silu_fast(y0.w)); w1.x = pk2(silu_fast(y1.x), silu_fast(y1.y)); w1.y = pk2(silu_fast(y1.z), silu_fast(y1.w));
            bf16* orow = F.MIX + (size_t)(t0 + tok) * D;
            *(v2u*)(orow + 4 * lane) = w0; *(v2u*)(orow + 256 + 4 * lane) = w1;
        }
        {
            f32x4 acc[2][4];
#pragma unroll
            for (int m = 0; m < 2; ++m)
#pragma unroll
                for (int n = 0; n < 4; ++n) acc[m][n] = (f32x4){0.f, 0.f, 0.f, 0.f};
#pragma unroll
            for (int k = 0; k < 4; ++k) {
                bf16x8 av[2];
#pragma unroll
                for (int m = 0; m < 2; ++m) av[m] = *(const LAS bf16x8*)(F.lds + P2_DA_OFF + (16 * m + fr) * P2_DA_PITCH + (pg * 128 + 32 * k + 8 * fq) * 2);
#pragma unroll
                for (int n = 0; n < 4; ++n) {
                    const bf16x8 wv = *(const bf16x8*)(F.PoolW_t + (size_t)(pg * 128 + 64 * nh + 16 * n + fr) * 128 + 32 * k + 8 * fq);
#pragma unroll
                    for (int m = 0; m < 2; ++m) acc[m][n] = __builtin_amdgcn_mfma_f32_16x16x32_bf16(wv, av[m], acc[m][n], 0, 0, 0);
                }
            }
#pragma unroll
            for (int n = 0; n < 4; ++n) {
                const int ch = pg * 128 + 64 * nh + 16 * n + 4 * fq; const f32x4 sc = *(const f32x4*)(F.pool_scale + ch);
#pragma unroll
                for (int m = 0; m < 2; ++m) { const f32x4 v = acc[m][n] * sc; v2u w; w.x = pk2(v.x, v.y); w.y = pk2(v.z, v.w);
                    *(v2u*)(F.MIX + (size_t)(t0 + 16 * m + fr) * D + 512 + ch) = w; }
            }
        }
        __syncthreads();
    }
}

__device__ __forceinline__ void p5_act_elementwise(Frame& F) {
    const long NI = (long)M * (DFF / 8), stride = (long)F.G * NWAVES * 64;
    for (long it = (long)F.vcu * NWAVES * 64 + F.tid; it < NI; it += stride) {
        const int row = (int)(it / (DFF / 8)), c8 = (int)(it % (DFF / 8)) * 8, sp = row & (SEQ - 1);
        const v4u g2 = *(const v4u*)(F.Gb + (size_t)row * DFF + c8);
        const v4u g1 = sp >= 1 ? *(const v4u*)(F.Gb + (size_t)(row - 1) * DFF + c8) : (v4u){0u, 0u, 0u, 0u};
        const v4u g0 = sp >= 2 ? *(const v4u*)(F.Gb + (size_t)(row - 2) * DFF + c8) : (v4u){0u, 0u, 0u, 0u};
        const v4u vv = *(const v4u*)(F.ACT + (size_t)row * DFF + c8);
        v4u o;
#pragma unroll
        for (int q = 0; q < 4; ++q) {
            const int c = c8 + 2 * q;
            const f32x2 w0 = *(const f32x2*)(F.conv_f_w + c), w1 = *(const f32x2*)(F.conv_f_w + DFF + c), w2 = *(const f32x2*)(F.conv_f_w + 2 * DFF + c), b = *(const f32x2*)(F.conv_f_b + c);
            const float p0 = w0.x * bflo(g0[q]) + w1.x * bflo(g1[q]) + w2.x * bflo(g2[q]) + b.x;
            const float p1 = w0.y * bfhi(g0[q]) + w1.y * bfhi(g1[q]) + w2.y * bfhi(g2[q]) + b.y;
            o[q] = pk2(silu_fast(p0) * bflo(vv[q]), silu_fast(p1) * bfhi(vv[q]));
        }
        *(v4u*)(F.ACT + (size_t)row * DFF + c8) = o;
    }
}
__device__ __forceinline__ void p7_final_norm(Frame& F) {
    const int gw = F.vcu * NWAVES + F.wave, NGW = F.G * NWAVES;
    f32x4 gv[4];
#pragma unroll
    for (int j = 0; j < 4; ++j) gv[j] = ((const f32x4*)F.norm_final_g)[F.lane + 64 * j];
    for (int m = gw; m < M; m += NGW) {
        GAS f32x4* xr = (GAS f32x4*)(F.out + (size_t)m * D) + F.lane;
        f32x4 v[4]; float s = 0.f;
#pragma unroll
        for (int j = 0; j < 4; ++j) { v[j] = xr[64 * j]; s += (v[j].x * v[j].x + v[j].y * v[j].y) + (v[j].z * v[j].z + v[j].w * v[j].w); }
        const float rstd = 1.f / sqrtf(wave_sum(s) * (1.f / D) + EPS);
#pragma unroll
        for (int j = 0; j < 4; ++j) xr[64 * j] = v[j] * rstd * gv[j];
    }
}

struct Args { const float* in[16]; float* out; unsigned char* ws; int ph_lo, ph_hi; };
__global__ void __launch_bounds__(NWAVES * 64, 2) skel_fwd(Args args) {
    extern __shared__ __attribute__((aligned(16))) unsigned char lds[];
    Frame F;
    F.lds = (LAS unsigned char*)lds;
    F.MISC = (volatile LAS unsigned*)(F.lds + MISC_OFF);
    F.tid = threadIdx.x; F.lane = F.tid & 63; F.wave = __builtin_amdgcn_readfirstlane(F.tid >> 6);
    F.G = gridDim.x; { const int bx = blockIdx.x; F.vcu = (F.G % 8 == 0) ? (bx % 8) * (F.G / 8) + bx / 8 : bx; }
    unsigned char* ws = args.ws;
    F.ctl = (gu32*)(ws + WS_CTL);
    F.x = args.in[0]; F.norm_mix_g = args.in[1]; F.w_in = args.in[2]; F.conv_a_w = args.in[3]; F.conv_a_b = args.in[4]; F.ln_a_g = args.in[5]; F.ln_a_b = args.in[6];
    F.pool_w = args.in[7]; F.pool_scale = args.in[8]; F.w_out = args.in[9]; F.norm_ffn_g = args.in[10]; F.w_up = args.in[11]; F.conv_f_w = args.in[12]; F.conv_f_b = args.in[13];
    F.w_down = args.in[14]; F.norm_final_g = args.in[15]; F.out = args.out;
    F.Win_t = (bf16*)(ws + WS_WIN); F.Wout_t = (bf16*)(ws + WS_WOUT); F.Wup_t = (bf16*)(ws + WS_WUP); F.Wdown_t = (bf16*)(ws + WS_WDOWN); F.PoolW_t = (bf16*)(ws + WS_POOLW);
    F.SSQ = (float*)(ws + WS_SSQ); F.XN = (bf16*)(ws + WS_XN); F.U = (bf16*)(ws + WS_U); F.MIX = (bf16*)(ws + WS_MIX); F.Gb = (bf16*)(ws + WS_G); F.ACT = (bf16*)(ws + WS_ACT);
    for (int u = F.tid; u < (LDS_BYTES - LDSCTL_OFF) / 4; u += NWAVES * 64) ((LAS unsigned*)(F.lds + LDSCTL_OFF))[u] = 0u;
    __syncthreads();
    XcdBarrier bar; bar.bar = (unsigned*)(F.ctl + CW_BAR); bar.x = 0; bar.st = nullptr;
    if (N_LAUNCHES == 1) bar = xcd_barrier_post((unsigned*)(F.ctl + CW_BAR), F.MISC + 8);
#define GRID_BAR() do { if (N_LAUNCHES == 1) xcd_barrier(bar); } while (0)
    const int lo = args.ph_lo, hi = args.ph_hi;
#define IN(k) (lo <= (k) && (k) < hi)
#define BOTH(k) (IN(k) && IN((k) + 1))

    if (IN(0)) { p0_prologue(F); if (BOTH(0)) GRID_BAR(); }
    if (IN(1)) {
        pg8::Gemm g{F.XN, F.Win_t, M, DIN, D}; pg8::StaticOrder S; S.init(M, DIN, F.G, (int)blockIdx.x);
        pg8::EpiIn E{F.U};
        pg8::gemm_phase<pg8::EpiIn, pg8::StaticOrder, true, true>(F.lds + RING_OFF, g, S, E);
        if (BOTH(1)) GRID_BAR();
    }
    if (IN(2)) { p2_mixers(F); if (BOTH(2)) GRID_BAR(); }
    if (IN(3)) {
        pg8::Gemm g{F.MIX, F.Wout_t, M, D, D}; pg8::StaticOrder S; S.init(M, D, F.G, (int)blockIdx.x);
        pg8::EpiOut E{F.x, F.out, F.XN, F.SSQ};
        pg8::gemm_phase<pg8::EpiOut, pg8::StaticOrder, true, true>(F.lds + RING_OFF, g, S, E);
        if (BOTH(3)) GRID_BAR();
    }
    if (IN(4)) {
        pg8::Gemm g{F.XN, F.Wup_t, M, NUP, D}; pg8::StaticOrder S; S.init(M, NUP, F.G, (int)blockIdx.x);
        pg8::EpiUpRaw E{F.Gb, F.ACT, F.SSQ};
        pg8::gemm_phase<pg8::EpiUpRaw, pg8::StaticOrder, true, true>(F.lds + RING_OFF, g, S, E);
        if (BOTH(4)) GRID_BAR();
    }
    if (IN(5)) { p5_act_elementwise(F); if (BOTH(5)) GRID_BAR(); }
    if (IN(6)) {
        pg8::Gemm g{F.ACT, F.Wdown_t, M, D, DFF}; pg8::StaticOrder S; S.init(M, D, F.G, (int)blockIdx.x);
        pg8::EpiDown E{F.out};
        pg8::gemm_phase<pg8::EpiDown, pg8::StaticOrder, true, true>(F.lds + RING_OFF, g, S, E);
        if (BOTH(6)) GRID_BAR();
    }
    if (IN(7)) { p7_final_norm(F); }
#undef IN
#undef BOTH
}

extern "C" void kernel_launch(void* const* d_in, const int* in_sizes, int n_in, void* d_out, int out_size, void* d_ws, size_t ws_size, hipStream_t stream) {
    static int grid = 0;
    if (grid == 0) {
        if (n_in != 16 || in_sizes[0] != M * D || out_size != M * D || ws_size < WS_END) { fprintf(stderr, "kernel_launch: unexpected shapes (n_in %d in0 %d out %d ws %zu)\n", n_in, n_in > 0 ? in_sizes[0] : -1, out_size, ws_size); grid = -1; return; }
        int dev = 0, cus = 0, per_cu = 0;
        if (hipGetDevice(&dev) != hipSuccess || hipDeviceGetAttribute(&cus, hipDeviceAttributeMultiprocessorCount, dev) != hipSuccess) { grid = -1; return; }
        if (hipFuncSetAttribute((const void*)skel_fwd, hipFuncAttributeMaxDynamicSharedMemorySize, LDS_BYTES) != hipSuccess) { fprintf(stderr, "kernel_launch: hipFuncSetAttribute failed\n"); grid = -1; return; }
        if (hipOccupancyMaxActiveBlocksPerMultiprocessor(&per_cu, (const void*)skel_fwd, NWAVES * 64, LDS_BYTES) != hipSuccess || per_cu < 1) fprintf(stderr, "kernel_launch: occupancy query says %d per CU\n", per_cu);
        (void)hipGetLastError();
        grid = cus;
    }
    if (grid < 0) return;
    if (hipMemsetAsync((char*)d_ws + WS_CTL, 0, CTL_ZERO_BYTES, stream) != hipSuccess) { fprintf(stderr, "kernel_launch: memset failed\n"); return; }
    Args a{};
    for (int i = 0; i < 16; ++i) a.in[i] = (const float*)d_in[i];
    a.out = (float*)d_out; a.ws = (unsigned char*)d_ws;
    if (N_LAUNCHES == 1) { a.ph_lo = 0; a.ph_hi = PER_PHASE; hipLaunchKernelGGL(skel_fwd, dim3(grid), dim3(NWAVES * 64), LDS_BYTES, stream, a); }
    else for (int li = 0; li < PER_PHASE; ++li) { a.ph_lo = li; a.ph_hi = li + 1; hipLaunchKernelGGL(skel_fwd, dim3(grid), dim3(NWAVES * 64), LDS_BYTES, stream, a); }
    const hipError_t le = hipPeekAtLastError();
    if (le != hipSuccess) fprintf(stderr, "kernel_launch: launch failed: %s\n", hipGetErrorName(le));
}
```
